# Optimizing an MI355X kernel written in HIP

```python
import jax, jax.numpy as jnp
from jax import lax
import numpy as np

D_MODEL = 1024
BATCH = 2
SEQ = 16384
DEPTH = 1

HEAD_DIM = 128
N_Q_HEADS = D_MODEL // HEAD_DIM
N_KV_HEADS = 2
D_ATTN = N_Q_HEADS * HEAD_DIM
D_KV = N_KV_HEADS * HEAD_DIM
WINDOW = 128
BLOCK = 128
ROPE_THETA = 10000.0
D_RNN = (5 * D_MODEL) // 4
RNN_BLOCK_W = 128
N_RNN_BLOCKS = D_RNN // RNN_BLOCK_W
CONV_W = 4
CONV_LEFT = 2
LRU_C = 8.0
N_DIRS = 2
ALPHA = (2.0 * DEPTH) ** 0.25
BETA = (8.0 * DEPTH) ** -0.25
LN_EPS = 1e-5

kernel_name = "hybrid_swa_rglru_deepnorm_encoder"


def _rope(t, pos):
    half = HEAD_DIM // 2
    inv = ROPE_THETA ** (-jnp.arange(half, dtype=jnp.float32) * (2.0 / HEAD_DIM))
    ang = pos.astype(jnp.float32)[:, None] * inv[None, :]
    cos = jnp.cos(ang)[None, :, None, :]
    sin = jnp.sin(ang)[None, :, None, :]
    t32 = t.astype(jnp.float32)
    t1, t2 = t32[..., :half], t32[..., half:]
    out = jnp.concatenate([t1 * cos - t2 * sin, t2 * cos + t1 * sin], axis=-1)
    return out.astype(t.dtype)


def _window_attention(q, k, v, sink):
    B, S = q.shape[0], q.shape[1]
    nb = S // BLOCK
    G = N_Q_HEADS // N_KV_HEADS
    qb = q.astype(jnp.float32).reshape(B, nb, BLOCK, N_KV_HEADS, G, HEAD_DIM)

    def band(t):
        tp = jnp.pad(t.astype(jnp.float32).reshape(B, nb, BLOCK, N_KV_HEADS, HEAD_DIM),
                     ((0, 0), (1, 1), (0, 0), (0, 0), (0, 0)))
        return jnp.concatenate([tp[:, :-2], tp[:, 1:-1], tp[:, 2:]], axis=2)

    kb, vb = band(k), band(v)
    s = jnp.einsum('bnqhgd,bnkhd->bnhgqk', qb, kb) * (HEAD_DIM ** -0.5)
    blk = jnp.arange(nb)[:, None]
    qpos = blk * BLOCK + jnp.arange(BLOCK)[None, :]
    kpos = (blk - 1) * BLOCK + jnp.arange(3 * BLOCK)[None, :]
    valid = ((jnp.abs(qpos[:, :, None] - kpos[:, None, :]) <= WINDOW)
             & (kpos[:, None, :] >= 0) & (kpos[:, None, :] < S))
    s = jnp.where(valid[None, :, None, None], s, -jnp.inf)
    sk = sink.astype(jnp.float32).reshape(N_KV_HEADS, G)[None, None, :, :, None, None]
    m = jnp.maximum(jnp.max(s, axis=-1, keepdims=True), sk)
    p = jnp.exp(s - m)
    denom = jnp.sum(p, axis=-1, keepdims=True) + jnp.exp(sk - m)
    o = jnp.einsum('bnhgqk,bnkhd->bnqhgd', p / denom, vb)
    return o.reshape(B, S, N_Q_HEADS * HEAD_DIM).astype(q.dtype)


def _centred_depthwise_conv(u, w, b):
    S = u.shape[1]
    up = jnp.pad(u, ((0, 0), (CONV_LEFT, CONV_W - 1 - CONV_LEFT), (0, 0)))
    y = b
    for j in range(CONV_W):
        y = y + w[j] * up[:, j:j + S]
    return y


def _linear_scan(a, u, reverse):
    def step(h, au):
        a_t, u_t = au
        h = a_t * h + u_t
        return h, h
    h0 = jnp.zeros((a.shape[0], a.shape[2]), jnp.float32)
    _, hs = lax.scan(step, h0, (jnp.swapaxes(a, 0, 1), jnp.swapaxes(u, 0, 1)), reverse=reverse)
    return jnp.swapaxes(hs, 0, 1)


def _bidirectional_rglru(xc, wa, ba, wx, bx, lam):
    B, S = xc.shape[0], xc.shape[1]
    x32 = xc.astype(jnp.float32)
    xb = x32.reshape(B, S, N_RNN_BLOCKS, RNN_BLOCK_W)
    r = jax.nn.sigmoid(jnp.einsum('bsni,dnij->bsdnj', xb, wa.astype(jnp.float32))
                       .reshape(B, S, N_DIRS, D_RNN) + ba.astype(jnp.float32))
    i = jax.nn.sigmoid(jnp.einsum('bsni,dnij->bsdnj', xb, wx.astype(jnp.float32))
                       .reshape(B, S, N_DIRS, D_RNN) + bx.astype(jnp.float32))
    log_a = -LRU_C * r * jax.nn.softplus(-lam.astype(jnp.float32))
    a = jnp.exp(log_a)
    u = jnp.sqrt(-jnp.expm1(2.0 * log_a)) * (i * x32[:, :, None, :])
    h_fwd = _linear_scan(a[:, :, 0], u[:, :, 0], reverse=False)
    h_bwd = _linear_scan(a[:, :, 1], u[:, :, 1], reverse=True)
    return (h_fwd + h_bwd).astype(xc.dtype)


def _layernorm(x, g, b):
    x32 = x.astype(jnp.float32)
    mu = jnp.mean(x32, axis=-1, keepdims=True)
    var = jnp.mean(jnp.square(x32 - mu), axis=-1, keepdims=True)
    y = (x32 - mu) * lax.rsqrt(var + LN_EPS) * g.astype(jnp.float32) + b.astype(jnp.float32)
    return y.astype(x.dtype)


def setup_inputs(seed: int = 0) -> dict:
    key = jax.random.key(seed)
    ks = jax.random.split(key, 20)
    total = 2 * D_ATTN + 2 * D_KV + 2 * D_RNN + 2 * D_MODEL
    f32 = jnp.float32
    x = jax.random.normal(ks[0], (BATCH, SEQ, D_MODEL), f32)
    col_scale = jnp.concatenate([
        jnp.ones((D_ATTN + D_KV,), f32),
        jnp.full((D_KV,), BETA, f32),
        jnp.ones((D_ATTN + 2 * D_RNN + 2 * D_MODEL,), f32)])
    w_in = jax.random.normal(ks[1], (DEPTH, D_MODEL, total), f32) * (D_MODEL ** -0.5) * col_scale
    b_in = 0.01 * jax.random.normal(ks[2], (DEPTH, total), f32)
    attn_sink = 0.5 * jax.random.normal(ks[3], (DEPTH, N_Q_HEADS), f32)
    conv_w = 0.5 * jax.random.normal(ks[4], (DEPTH, CONV_W, D_RNN), f32)
    conv_b = 0.01 * jax.random.normal(ks[5], (DEPTH, D_RNN), f32)
    gshape = (DEPTH, N_DIRS, N_RNN_BLOCKS, RNN_BLOCK_W, RNN_BLOCK_W)
    lru_wa = jax.random.normal(ks[6], gshape, f32) * (RNN_BLOCK_W ** -0.5)
    lru_ba = 0.01 * jax.random.normal(ks[7], (DEPTH, N_DIRS, D_RNN), f32)
    lru_wx = jax.random.normal(ks[8], gshape, f32) * (RNN_BLOCK_W ** -0.5)
    lru_bx = 0.01 * jax.random.normal(ks[9], (DEPTH, N_DIRS, D_RNN), f32)
    a_c = jax.random.uniform(ks[10], (DEPTH, N_DIRS, D_RNN), f32, 0.9, 0.999)
    a0 = a_c ** (1.0 / LRU_C)
    lru_lambda = jnp.log(a0) - jnp.log1p(-a0)
    w_branch_attn = jax.random.normal(ks[11], (DEPTH, D_ATTN, D_MODEL), f32) * (D_ATTN ** -0.5) * BETA
    w_branch_rnn = jax.random.normal(ks[12], (DEPTH, D_RNN, D_MODEL), f32) * (D_RNN ** -0.5) * BETA
    w_out = jax.random.normal(ks[13], (DEPTH, D_MODEL, D_MODEL), f32) * (D_MODEL ** -0.5) * BETA
    b_out = 0.01 * jax.random.normal(ks[14], (DEPTH, D_MODEL), f32)
    ln_gain = 1.0 + 0.02 * jax.random.normal(ks[15], (DEPTH, D_MODEL), f32)
    ln_bias = 0.02 * jax.random.normal(ks[16], (DEPTH, D_MODEL), f32)
    return {"x": x, "w_in": w_in, "b_in": b_in, "attn_sink": attn_sink,
            "conv_w": conv_w, "conv_b": conv_b, "lru_wa": lru_wa, "lru_ba": lru_ba,
            "lru_wx": lru_wx, "lru_bx": lru_bx, "lru_lambda": lru_lambda,
            "w_branch_attn": w_branch_attn, "w_branch_rnn": w_branch_rnn,
            "w_out": w_out, "b_out": b_out, "ln_gain": ln_gain, "ln_bias": ln_bias}


def reference(x, w_in, b_in, attn_sink, conv_w, conv_b, lru_wa, lru_ba, lru_wx, lru_bx,
              lru_lambda, w_branch_attn, w_branch_rnn, w_out, b_out, ln_gain, ln_bias):
    B, S = x.shape[0], x.shape[1]
    sizes = (D_ATTN, D_KV, D_KV, D_ATTN, D_RNN, D_RNN, D_MODEL, D_MODEL)
    split_at = [int(c) for c in np.cumsum(sizes)[:-1]]
    pos = jnp.arange(S)
    for l in range(DEPTH):
        proj = jnp.einsum('bsd,de->bse', x, w_in[l]) + b_in[l]
        q, k, v, g_attn, x_rnn, g_rnn, m_attn, m_rnn = jnp.split(proj, split_at, axis=-1)
        q = _rope(q.reshape(B, S, N_Q_HEADS, HEAD_DIM), pos)
        k = _rope(k.reshape(B, S, N_KV_HEADS, HEAD_DIM), pos)
        v = v.reshape(B, S, N_KV_HEADS, HEAD_DIM)
        attn = _window_attention(q, k, v, attn_sink[l]) * jax.nn.silu(g_attn)
        xc = _centred_depthwise_conv(x_rnn, conv_w[l], conv_b[l])
        rnn = _bidirectional_rglru(xc, lru_wa[l], lru_ba[l], lru_wx[l], lru_bx[l],
                                   lru_lambda[l]) * jax.nn.silu(g_rnn)
        merged = (jax.nn.sigmoid(m_attn) * jnp.einsum('bse,ed->bsd', attn, w_branch_attn[l])
                  + jax.nn.sigmoid(m_rnn) * jnp.einsum('bse,ed->bsd', rnn, w_branch_rnn[l]))
        out = jnp.einsum('bsd,de->bse', merged, w_out[l]) + b_out[l]
        x = _layernorm(ALPHA * x + out, ln_gain[l], ln_bias[l])
    return x
```

```cpp
#include <hip/hip_runtime.h>
#include <cstdio>
#include <cstdint>

#ifndef MK_N_LAUNCHES
#define MK_N_LAUNCHES 10
#endif

namespace pg8 {
#define PG8_LAS __attribute__((address_space(3)))
typedef unsigned short bf16_t;
typedef short bf16x8 __attribute__((ext_vector_type(8)));
typedef float f32x4 __attribute__((ext_vector_type(4)));
typedef unsigned u32x4 __attribute__((ext_vector_type(4)));
typedef unsigned u32x2 __attribute__((ext_vector_type(2)));
constexpr int BM = 256, BK = 64, HALF = 128, HTB = HALF * BK * 2, STAGE_BYTES = 8 * HTB, NXCD = 8, WGM = 8;

__host__ __device__ __forceinline__ int lds_byte(int r, int c) { const int st = (r >> 4) * 2 + (c >> 5), rr = r & 15, cc = c & 31, ob = rr * 64 + cc * 2; return st * 1024 + (ob ^ (((ob >> 9) & 1) << 5)); }
__host__ __device__ __forceinline__ void stage_rc(int b, int& R, int& C) { const int st = b / 1024, sb = b % 1024, swz = sb ^ (((sb >> 9) & 1) << 5); R = (st >> 1) * 16 + swz / 64; C = (st & 1) * 32 + (swz % 64) / 2; }
__host__ __device__ __forceinline__ int perm32(int rho) { const int n = rho >> 4, i = rho & 15; return 8 * (i >> 2) + 4 * n + (i & 3); }

struct Unit { int pm, pn; };
struct Gemm { const bf16_t* A; const bf16_t* Bt; int lda, ldb, M, N, K; };

struct StaticOrder {
    int nM, nN, nwg, G, c;
    __host__ __device__ void init(int M, int N, int G_, int c_) { nM = M / BM; nN = N / BM; nwg = nM * nN; G = G_; c = c_; }
    __host__ __device__ bool next(int i, Unit& u) const {
        const long L = (long)i * G + c; if (L >= nwg) return false;
        int wgid = (int)L; { const int q = nwg / NXCD, r = nwg % NXCD, xcd = wgid % NXCD, off = wgid / NXCD; wgid = (xcd < r ? xcd * (q + 1) : r * (q + 1) + (xcd - r) * q) + off; }
        const int nig = WGM * nN, gid = wgid / nig, fm = gid * WGM, gsz = (nM - fm) < WGM ? (nM - fm) : WGM;
        u.pm = fm + ((wgid % nig) % gsz); u.pn = (wgid % nig) / gsz; return true;
    }
    __device__ __forceinline__ void a_ready(const Unit&) const {}
    __device__ __forceinline__ void done(const Unit&) const {}
};

__device__ __forceinline__ unsigned cvt_pk_bf16(float lo, float hi) { unsigned r; asm volatile("v_cvt_pk_bf16_f32 %0, %1, %2" : "=v"(r) : "v"(lo), "v"(hi)); return r; }
__device__ __forceinline__ float bf_lo(unsigned w) { return __uint_as_float(w << 16); }
__device__ __forceinline__ float bf_hi(unsigned w) { return __uint_as_float(w & 0xffff0000u); }

template <class Epi, class Sched, bool ALIGN_EPI = false, bool SP2 = false>
__device__ __forceinline__ void gemm_phase(PG8_LAS unsigned char* lds, const Gemm g, const Sched& S, const Epi& E) {
    const int tid = threadIdx.x, wid = __builtin_amdgcn_readfirstlane(tid >> 6), lane = tid & 63, wr = wid >> 2, wc = wid & 3, fr = lane & 15, fq = lane >> 4;
    const int K = g.K, nt = K / BK;
    unsigned voffA[2], voffB[2];
#pragma unroll
    for (int i = 0; i < 2; ++i) { int R, C; stage_rc(tid * 16 + i * 8192, R, C); const int Rb = Epi::PERM ? ((R & ~31) + perm32(R & 31)) : R;
        voffA[i] = (unsigned)(R * g.lda + C) * 2u; voffB[i] = (unsigned)(Rb * g.ldb + C) * 2u; }
    const size_t kstep = (size_t)(BK * 2);
    const size_t hstepA = (size_t)HALF * g.lda * 2, hstepB = (size_t)HALF * g.ldb * 2;
    const size_t tstepA = 2 * hstepA, tstepB = 2 * hstepB;
    const unsigned ldsw = (unsigned)wid * 1024u;
    const int aoff = lds_byte(wr * 64 + fr, fq * 8), boff = lds_byte(wc * 32 + fr, fq * 8);
#define PG8_SA(b, h) (((b) * 2 + (h)) * HTB)
#define PG8_SB(b, h) ((4 + (b) * 2 + (h)) * HTB)
#define PG8_STAGE(bufoff, gbase, voff) do { _Pragma("unroll") for (int _i = 0; _i < 2; ++_i) \
        __builtin_amdgcn_global_load_lds((const unsigned*)((const char*)(gbase) + (voff)[_i]), (PG8_LAS unsigned*)(lds + (bufoff) + ldsw + _i * 8192), 16, 0, 0); } while (0)
#define PG8_LDA(dst, b, h) do { _Pragma("unroll") for (int m = 0; m < 4; ++m) _Pragma("unroll") for (int k = 0; k < 2; ++k) dst[m][k] = *(const PG8_LAS bf16x8*)(lds + PG8_SA(b, h) + aoff + m * 2048 + k * 1024); } while (0)
#define PG8_LDB(dst, b, h) do { _Pragma("unroll") for (int n = 0; n < 2; ++n) _Pragma("unroll") for (int k = 0; k < 2; ++k) dst[n][k] = *(const PG8_LAS bf16x8*)(lds + PG8_SB(b, h) + boff + n * 2048 + k * 1024); } while (0)
#define PG8_MMA(ai, bj, At, Bt) do { __builtin_amdgcn_s_setprio(1); _Pragma("unroll") for (int m = 0; m < 4; ++m) _Pragma("unroll") for (int n = 0; n < 2; ++n) _Pragma("unroll") for (int k = 0; k < 2; ++k) \
        acc[ai][bj][m][n] = __builtin_amdgcn_mfma_f32_16x16x32_bf16(Bt[n][k], At[m][k], acc[ai][bj][m][n], 0, 0, 0); __builtin_amdgcn_s_setprio(0); } while (0)
#define PG8_WAIT_V(n) asm volatile("s_waitcnt vmcnt(" #n ")" ::: "memory")
#define PG8_WAIT_L(n) asm volatile("s_waitcnt lgkmcnt(" #n ")" ::: "memory")
#define PG8_BAR __builtin_amdgcn_s_barrier()
#define PG8_SCHED __builtin_amdgcn_sched_barrier(0)
    Unit cur, nxt; int ui = 0;
    if (!S.next(0, cur)) return;
    f32x4 acc[2][2][4][2];
#pragma unroll
    for (int a = 0; a < 2; ++a)
#pragma unroll
        for (int b = 0; b < 2; ++b)
#pragma unroll
            for (int m = 0; m < 4; ++m)
#pragma unroll
                for (int n = 0; n < 2; ++n) acc[a][b][m][n] = (f32x4){0.f, 0.f, 0.f, 0.f};
    bf16x8 At[4][2], B0[2][2], B1[2][2];
    const char* cA = (const char*)g.A + (size_t)cur.pm * tstepA; const char* cB = (const char*)g.Bt + (size_t)cur.pn * tstepB;
    S.a_ready(cur);
    if constexpr (SP2) {
        PG8_STAGE(PG8_SB(0, 0), cB, voffB); PG8_STAGE(PG8_SB(0, 1), cB + hstepB, voffB); PG8_STAGE(PG8_SA(0, 0), cA, voffA); PG8_STAGE(PG8_SA(0, 1), cA + hstepA, voffA);
        if (wr == 1) PG8_BAR;
        PG8_WAIT_V(2); PG8_BAR;
        PG8_STAGE(PG8_SB(1, 0), cB + kstep, voffB); PG8_STAGE(PG8_SA(1, 0), cA + kstep, voffA); PG8_STAGE(PG8_SB(1, 1), cB + hstepB + kstep, voffB);
        PG8_WAIT_V(6); PG8_BAR;
    } else {
        PG8_STAGE(PG8_SB(0, 0), cB, voffB); PG8_STAGE(PG8_SA(0, 0), cA, voffA); PG8_STAGE(PG8_SB(0, 1), cB + hstepB, voffB); PG8_STAGE(PG8_SA(0, 1), cA + hstepA, voffA);
        if (wr == 1) PG8_BAR;
        PG8_WAIT_V(4); PG8_BAR;
        PG8_STAGE(PG8_SB(1, 0), cB + kstep, voffB); PG8_STAGE(PG8_SA(1, 0), cA + kstep, voffA); PG8_STAGE(PG8_SB(1, 1), cB + hstepB + kstep, voffB);
        PG8_WAIT_V(6); PG8_BAR;
    }
    for (;;) {
        const bool has_next = S.next(ui + 1, nxt);
        const char* nA = has_next ? (const char*)g.A + (size_t)nxt.pm * tstepA : cA; const char* nB = has_next ? (const char*)g.Bt + (size_t)nxt.pn * tstepB : cB;
        for (int t = 0; t < nt; t += 2) {
            const bool last = (t == nt - 2);
            const char* a1 = cA + (size_t)(t + 1) * kstep;
            const char* a2 = last ? nA : cA + (size_t)(t + 2) * kstep; const char* b2 = last ? nB : cB + (size_t)(t + 2) * kstep;
            const char* a3 = a2 + kstep; const char* b3 = b2 + kstep;
            if (last && has_next) S.a_ready(nxt);
            if constexpr (SP2) {
            PG8_LDB(B0, 0, 0); PG8_LDB(B1, 0, 1); PG8_SCHED; PG8_LDA(At, 0, 0); PG8_STAGE(PG8_SA(1, 1), a1 + hstepA, voffA);
            PG8_WAIT_V(8); PG8_WAIT_L(0); PG8_BAR; PG8_MMA(0, 0, At, B0); PG8_MMA(0, 1, At, B1); PG8_BAR; PG8_SCHED;
            PG8_LDA(At, 0, 1); PG8_STAGE(PG8_SB(0, 0), b2, voffB); PG8_STAGE(PG8_SB(0, 1), b2 + hstepB, voffB); PG8_STAGE(PG8_SA(0, 0), a2, voffA);
            PG8_WAIT_V(8); PG8_WAIT_L(0); PG8_BAR; PG8_MMA(1, 0, At, B0); PG8_MMA(1, 1, At, B1); PG8_BAR; PG8_SCHED;
            PG8_LDB(B0, 1, 0); PG8_LDB(B1, 1, 1); PG8_SCHED; PG8_LDA(At, 1, 0); PG8_STAGE(PG8_SA(0, 1), a2 + hstepA, voffA);
            PG8_WAIT_V(8); PG8_WAIT_L(0); PG8_BAR; PG8_MMA(0, 0, At, B0); PG8_MMA(0, 1, At, B1); PG8_BAR; PG8_SCHED;
            PG8_LDA(At, 1, 1); PG8_STAGE(PG8_SB(1, 0), b3, voffB); PG8_STAGE(PG8_SB(1, 1), b3 + hstepB, voffB); PG8_STAGE(PG8_SA(1, 0), a3, voffA);
            PG8_WAIT_V(8); PG8_WAIT_L(0); PG8_BAR; PG8_MMA(1, 0, At, B0); PG8_MMA(1, 1, At, B1); PG8_BAR; PG8_SCHED;
            } else {
            PG8_LDB(B0, 0, 0); PG8_SCHED; PG8_LDA(At, 0, 0); PG8_STAGE(PG8_SA(1, 1), a1 + hstepA, voffA);
            PG8_WAIT_L(8); PG8_BAR; PG8_WAIT_L(0); PG8_MMA(0, 0, At, B0); PG8_BAR; PG8_SCHED;
            PG8_LDB(B1, 0, 1); PG8_STAGE(PG8_SB(0, 0), b2, voffB);
            PG8_BAR; PG8_WAIT_L(0); PG8_MMA(0, 1, At, B1); PG8_BAR;
            PG8_LDA(At, 0, 1); PG8_STAGE(PG8_SA(0, 0), a2, voffA);
            PG8_BAR; PG8_WAIT_L(0); PG8_MMA(1, 0, At, B0); PG8_BAR; PG8_SCHED;
            PG8_STAGE(PG8_SB(0, 1), b2 + hstepB, voffB);
            PG8_WAIT_V(6); PG8_BAR; PG8_MMA(1, 1, At, B1); PG8_BAR;
            PG8_LDB(B0, 1, 0); PG8_SCHED; PG8_LDA(At, 1, 0); PG8_STAGE(PG8_SA(0, 1), a2 + hstepA, voffA);
            PG8_WAIT_L(8); PG8_BAR; PG8_WAIT_L(0); PG8_MMA(0, 0, At, B0); PG8_BAR; PG8_SCHED;
            PG8_LDB(B1, 1, 1); PG8_STAGE(PG8_SB(1, 0), b3, voffB);
            PG8_BAR; PG8_WAIT_L(0); PG8_MMA(0, 1, At, B1); PG8_BAR;
            PG8_LDA(At, 1, 1); PG8_STAGE(PG8_SA(1, 0), a3, voffA);
            PG8_BAR; PG8_WAIT_L(0); PG8_MMA(1, 0, At, B0); PG8_BAR; PG8_SCHED;
            PG8_STAGE(PG8_SB(1, 1), b3 + hstepB, voffB);
            PG8_WAIT_V(6); PG8_BAR; PG8_MMA(1, 1, At, B1); PG8_BAR;
            }
        }
        if constexpr (ALIGN_EPI) { if (wr == 0) PG8_BAR; }
        E(acc, cur, wr, wc, fr, fq); S.done(cur);
        if (!has_next) break;
#pragma unroll
        for (int a = 0; a < 2; ++a)
#pragma unroll
            for (int b = 0; b < 2; ++b)
#pragma unroll
                for (int m = 0; m < 4; ++m)
#pragma unroll
                    for (int n = 0; n < 2; ++n) acc[a][b][m][n] = (f32x4){0.f, 0.f, 0.f, 0.f};
        cur = nxt; cA = nA; cB = nB; ++ui;
        if constexpr (ALIGN_EPI) { if (wr == 1) PG8_BAR; }
    }
    PG8_WAIT_V(0);
    if constexpr (!ALIGN_EPI) { if (wr == 0) PG8_BAR; }
    PG8_BAR;
#undef PG8_SA
#undef PG8_SB
#undef PG8_STAGE
#undef PG8_LDA
#undef PG8_LDB
#undef PG8_MMA
#undef PG8_WAIT_V
#undef PG8_WAIT_L
#undef PG8_BAR
#undef PG8_SCHED
}
}

constexpr int NWAVES = 8;
constexpr int N_LAUNCHES = MK_N_LAUNCHES;
constexpr int N_PHASES = 10;
constexpr int BATCH = 2, SEQ = 16384, DM = 1024, T = BATCH * SEQ;
constexpr int HD = 128, NQH = 8, NKVH = 2, DKV = 256, DRNN = 1280, NRB = 10, NTOT = 7168;
constexpr int LCH = 64, NCH = SEQ / LCH;
constexpr float LN_EPS = 1e-5f;
constexpr float ALPHA = 1.189207115002721f;
constexpr float SM_SCALE = 0.088388347648318440f;
constexpr float LOG2E = 1.4426950408889634f;

constexpr size_t MiB = 1u << 20;
constexpr size_t WS_CTL = 0, CTL_ZERO_BYTES = 1 * MiB;
constexpr size_t WS_WIN = 1 * MiB;
constexpr size_t WS_WA = 16 * MiB;
constexpr size_t WS_WR = 18 * MiB;
constexpr size_t WS_WO = 21 * MiB;
constexpr size_t WS_WG = 23 * MiB;
constexpr size_t WS_BIAS = 24 * MiB + 512 * 1024;
constexpr size_t WS_ROPE = 25 * MiB;
constexpr size_t WS_AGG = 33 * MiB;
constexpr size_t WS_CAR = 44 * MiB;
constexpr size_t WS_XR = 64 * MiB;
constexpr size_t WS_GR = 144 * MiB;
constexpr size_t WS_HL = 224 * MiB;
constexpr size_t WS_PF = 304 * MiB;
constexpr size_t WS_PB = 384 * MiB;
constexpr size_t WS_Q = 64 * MiB;
constexpr size_t WS_GA = 128 * MiB;
constexpr size_t WS_K = 192 * MiB;
constexpr size_t WS_V = 208 * MiB;
constexpr size_t WS_MA = 304 * MiB;
constexpr size_t WS_MR = 368 * MiB;
constexpr size_t WS_MG = 432 * MiB;
constexpr size_t WS_END = 496 * MiB;

constexpr int CW_TMO = 0, CW_CODE = 1;
constexpr int CW_BAR = 4096;

constexpr int RING_OFF = 0, RING_BYTES = 131072;
constexpr int LDSCTL_OFF = RING_BYTES, MISC_OFF = LDSCTL_OFF + 320;
constexpr int LDS_BYTES = 147456;

#define GAS __attribute__((address_space(1)))
#define LAS __attribute__((address_space(3)))
typedef unsigned short bf16;
typedef unsigned v4u __attribute__((ext_vector_type(4)));
typedef float f32x4 __attribute__((ext_vector_type(4)));
typedef float f32x2 __attribute__((ext_vector_type(2)));
typedef short bf16x8 __attribute__((ext_vector_type(8)));
typedef GAS unsigned gu32;
#define RLX_AGENT __ATOMIC_RELAXED, __HIP_MEMORY_SCOPE_AGENT
#define LDS_WAIT() asm volatile("s_waitcnt lgkmcnt(0)" ::: "memory")
#define VM_WAIT() asm volatile("s_waitcnt vmcnt(0)" ::: "memory")
__device__ __forceinline__ unsigned f2bf(float f) { unsigned u = __builtin_bit_cast(unsigned, f); return (u + 0x7fffu + ((u >> 16) & 1u)) >> 16; }
__device__ __forceinline__ unsigned pk2(float lo, float hi) { return f2bf(lo) | (f2bf(hi) << 16); }
__device__ __forceinline__ float bflo(unsigned w) { return __uint_as_float(w << 16); }
__device__ __forceinline__ float bfhi(unsigned w) { return __uint_as_float(w & 0xffff0000u); }
__device__ __forceinline__ float fast_sigmoid(float x) { return __builtin_amdgcn_rcpf(1.0f + __builtin_amdgcn_exp2f(-LOG2E * x)); }
__device__ __forceinline__ float fast_silu(float x) { return x * fast_sigmoid(x); }

#define XB_TMO      128
#define XB_XCNT(j)  (256  + 64 * (j))
#define XB_XSUB(j)  (1280 + 64 * (j))
#define XB_XGEN(j)  (2304 + 64 * (j))
#define XB_TOP      3328
#define XB_TOPGEN   3392
#define XCD_BAR_WORDS 3456
#define XB_SPIN_CAP (1u << 18)
__device__ __forceinline__ unsigned xb_ld(unsigned* p)              { return __hip_atomic_load(p, __ATOMIC_RELAXED, __HIP_MEMORY_SCOPE_AGENT); }
__device__ __forceinline__ unsigned xb_add(unsigned* p, unsigned v) { return __hip_atomic_fetch_add(p, v, __ATOMIC_RELAXED, __HIP_MEMORY_SCOPE_AGENT); }
__device__ __forceinline__ unsigned xb_xcc_id() { return (unsigned)__builtin_amdgcn_s_getreg((3 << 11) | 20) & 0xFu; }
#define XB_SPIN(cond, bar) do { unsigned _sp = 0; while (cond) { __builtin_amdgcn_s_sleep(1); \
    if ((++_sp & 255u) == 0u) { if (xb_ld(&(bar)[XB_TMO])) break; if (_sp > XB_SPIN_CAP) { atomicAdd(&(bar)[XB_TMO], 1u); break; } } } } while (0)
struct XcdBarrier { unsigned* bar; unsigned x; volatile LAS unsigned* st; };
__device__ __forceinline__ XcdBarrier xcd_barrier_post(unsigned* bar, volatile LAS unsigned* st) {
    XcdBarrier b; b.bar = bar; b.x = xb_xcc_id(); b.st = st;
    if (threadIdx.x == 0) (void)xb_add(&bar[XB_XCNT(b.x)], 1u);
    return b;
}
__device__ __forceinline__ void xcd_barrier_complete(unsigned* bar, unsigned x, unsigned& nloc, unsigned& nx) {
    const unsigned G = gridDim.x * gridDim.y * gridDim.z;
    unsigned sum, cnt, mine, sp = 0u;
    for (;;) {
        sum = 0u; cnt = 0u; mine = 0u;
#pragma unroll
        for (unsigned j = 0; j < 16; ++j) { const unsigned c = xb_ld(&bar[XB_XCNT(j)]); sum += c; cnt += (c > 0u) ? 1u : 0u; mine = (j == x) ? c : mine; }
        if (sum == G) break;
        __builtin_amdgcn_s_sleep(1);
        if ((++sp & 255u) == 0u) { if (xb_ld(&bar[XB_TMO])) break; if (sp > XB_SPIN_CAP) { atomicAdd(&bar[XB_TMO], 1u); break; } }
    }
    nloc = mine > 0u ? mine : 1u; nx = cnt > 0u ? cnt : 1u;
}
__device__ __forceinline__ void xcd_barrier(const XcdBarrier& b) {
    asm volatile("s_waitcnt vmcnt(0)" ::: "memory");
    __syncthreads();
    if (threadIdx.x == 0) {
        unsigned* bar = b.bar;
        __builtin_amdgcn_s_waitcnt(0);
        unsigned nloc = b.st[0], nx = b.st[1];
        if (nloc == 0u) { xcd_barrier_complete(bar, b.x, nloc, nx); b.st[0] = nloc; b.st[1] = nx; }
        const unsigned old = xb_add(&bar[XB_XSUB(b.x)], 1u);
        const unsigned gen = old / nloc;
        if (old + 1u == (gen + 1u) * nloc) {
            __builtin_amdgcn_fence(__ATOMIC_RELEASE, "agent");
            asm volatile("s_waitcnt vmcnt(0)" ::: "memory");
            const unsigned og = xb_add(&bar[XB_TOP], 1u);
            const unsigned tg = og / nx;
            if (og + 1u == (tg + 1u) * nx) xb_add(&bar[XB_TOPGEN], 1u);
            else XB_SPIN(xb_ld(&bar[XB_TOPGEN]) == tg, bar);
            __builtin_amdgcn_fence(__ATOMIC_ACQUIRE, "agent");
            xb_add(&bar[XB_XGEN(b.x)], 1u);
            asm volatile("s_waitcnt vmcnt(0)" ::: "memory");
        } else {
            XB_SPIN(xb_ld(&bar[XB_XGEN(b.x)]) == gen, bar);
            __builtin_amdgcn_fence(__ATOMIC_ACQUIRE, "agent");
            asm volatile("s_waitcnt vmcnt(0)" ::: "memory");
        }
    }
    __syncthreads();
}

struct Frame {
    LAS unsigned char* lds;
    volatile LAS unsigned* MISC;
    gu32* ctl;
    int tid, lane, wave;
    int vcu, G;
    unsigned char* ws;
    const float *x, *w_in, *b_in, *sink, *conv_w, *conv_b, *lru_wa, *lru_ba, *lru_wx, *lru_bx, *lam, *w_ba, *w_br, *w_out, *b_out, *ln_g, *ln_b;
    float* out;
};

__device__ __forceinline__ void p0_transpose_item(const float* W, int ldw, bf16* WT, int ldt, int k0, int n0, int drow, LAS float* scr, int lane) {
#pragma unroll 8
    for (int i = 0; i < 32; ++i) { const int kk = 2 * i + (lane >> 5); scr[kk * 33 + (lane & 31)] = W[(size_t)(k0 + kk) * ldw + n0 + (lane & 31)]; }
    LDS_WAIT(); asm volatile("" ::: "memory");
    const int c = lane & 7;
#pragma unroll
    for (int j = 0; j < 4; ++j) { const int n = (lane >> 3) + 8 * j; const LAS float* s = scr + (8 * c) * 33 + n;
        v4u o; o.x = pk2(s[0 * 33], s[1 * 33]); o.y = pk2(s[2 * 33], s[3 * 33]); o.z = pk2(s[4 * 33], s[5 * 33]); o.w = pk2(s[6 * 33], s[7 * 33]);
        *(GAS v4u*)(WT + (size_t)(drow + n) * ldt + k0 + 8 * c) = o; }
    LDS_WAIT(); asm volatile("" ::: "memory");
}
__host__ __device__ __forceinline__ int win_dest_row(int n) {
    if (n < 1024) { const int head = n >> 7, d = n & 127; return 2560 + 256 * (head >> 1) + 128 * (d >> 6) + 64 * (head & 1) + (d & 63); }
    if (n < 1280) { const int n2 = n - 1024, head = n2 >> 7, d = n2 & 127; return 3584 + 128 * (d >> 6) + 64 * head + (d & 63); }
    if (n < 2560) return 2560 + n;
    if (n < 5120) return n - 2560;
    return n;
}
__device__ __forceinline__ void p0_prologue(Frame& F) {
    LAS float* scr = (LAS float*)(F.lds + RING_OFF + F.wave * 16384);
    const int gw = F.vcu * NWAVES + F.wave, NGW = F.G * NWAVES;
    bf16* Win_t = (bf16*)(F.ws + WS_WIN); bf16* Wa_t = (bf16*)(F.ws + WS_WA); bf16* Wr_t = (bf16*)(F.ws + WS_WR); bf16* Wo_t = (bf16*)(F.ws + WS_WO); bf16* Wg_t = (bf16*)(F.ws + WS_WG);
    constexpr int I_IN = (DM / 64) * (NTOT / 32);
    constexpr int I_A = (DM / 64) * (DM / 32);
    constexpr int I_R = (DRNN / 64) * (DM / 32);
    constexpr int I_O = I_A;
    constexpr int I_G = 40 * 8;
    constexpr int NITEMS = I_IN + I_A + I_R + I_O + I_G;
    for (int it = gw; it < NITEMS; it += NGW) {
        int r = it;
        if (r < I_IN) { const int nb = r % (NTOT / 32), kb = r / (NTOT / 32); p0_transpose_item(F.w_in, NTOT, Win_t, DM, 64 * kb, 32 * nb, win_dest_row(32 * nb), scr, F.lane); continue; } r -= I_IN;
        if (r < I_A) { const int nb = r % 32, kb = r / 32; p0_transpose_item(F.w_ba, DM, Wa_t, DM, 64 * kb, 32 * nb, 32 * nb, scr, F.lane); continue; } r -= I_A;
        if (r < I_R) { const int nb = r % 32, kb = r / 32; p0_transpose_item(F.w_br, DM, Wr_t, DRNN, 64 * kb, 32 * nb, 32 * nb, scr, F.lane); continue; } r -= I_R;
        if (r < I_O) { const int nb = r % 32, kb = r / 32; p0_transpose_item(F.w_out, DM, Wo_t, DM, 64 * kb, 32 * nb, 32 * nb, scr, F.lane); continue; } r -= I_O;
        { const int blk = r >> 3, sub = r & 7, kb = sub >> 2, nb = sub & 3;
          const int gate = blk / 20, rem = blk % 20;
          const float* src = (gate == 0 ? F.lru_wa : F.lru_wx) + (size_t)rem * 16384;
          p0_transpose_item(src, 128, Wg_t + (size_t)blk * 16384, 128, 64 * kb, 32 * nb, 32 * nb, scr, F.lane); }
    }
    const int gt = F.vcu * (NWAVES * 64) + F.tid, NGT = F.G * NWAVES * 64;
    float* biasp = (float*)(F.ws + WS_BIAS);
    for (int n = gt; n < NTOT; n += NGT) biasp[win_dest_row(n & ~31) + (n & 31)] = F.b_in[n];
    f32x2* rope = (f32x2*)(F.ws + WS_ROPE);
    for (int e = gt; e < SEQ * 64; e += NGT) { const int pos = e >> 6, d = e & 63;
        const float inv = (float)pow(10000.0, -(double)d * (1.0 / 64.0));
        const float ang = (float)pos * inv;
        rope[e] = (f32x2){(float)cos((double)ang), (float)sin((double)ang)}; }
    bf16* XB = (bf16*)F.out;
    for (size_t i = gt; i < (size_t)T * DM / 8; i += NGT) {
        const f32x4 a = *(const GAS f32x4*)(F.x + i * 8), b = *(const GAS f32x4*)(F.x + i * 8 + 4);
        v4u o; o.x = pk2(a.x, a.y); o.y = pk2(a.z, a.w); o.z = pk2(b.x, b.y); o.w = pk2(b.z, b.w);
        *(GAS v4u*)(XB + i * 8) = o; }
}

struct EpiProj {
    static constexpr bool PERM = true;
    unsigned char* ws; const float* biasp; int tile_base;
    __device__ __forceinline__ void operator()(const pg8::f32x4 (&acc)[2][2][4][2], const pg8::Unit& u, int wr, int wc, int fr, int fq) const {
        using namespace pg8;
        const int vt = u.pn + tile_base;
        const int row0 = u.pm * BM + wr * 64 + fr;
        const int vc0 = vt * 256 + wc * 32 + 8 * fq;
        f32x4 bv[2][2];
#pragma unroll
        for (int bj = 0; bj < 2; ++bj)
#pragma unroll
            for (int n = 0; n < 2; ++n) bv[bj][n] = *(const f32x4*)(biasp + vc0 + bj * HALF + 4 * n);
        if (vt >= 10 && vt <= 14) {
            bf16_t* dst; int pitch, head;
            if (vt < 14) { dst = (bf16_t*)(ws + WS_Q); pitch = DM; head = 2 * (vt - 10) + (wc >> 1); } else { dst = (bf16_t*)(ws + WS_K); pitch = DKV; head = (wc >> 1); }
            const int dlo = 32 * (wc & 1) + 8 * fq;
            const f32x4* rope = (const f32x4*)(ws + WS_ROPE);
#pragma unroll
            for (int ai = 0; ai < 2; ++ai)
#pragma unroll
                for (int m = 0; m < 4; ++m) {
                    const int row = row0 + ai * HALF + m * 16; const int pos = row & (SEQ - 1);
                    const f32x4* rp = rope + ((size_t)pos * 64 + dlo) / 2;
                    const f32x4 c0 = rp[0], c1 = rp[1], c2 = rp[2], c3 = rp[3];
                    const f32x4 t1a = acc[ai][0][m][0] + bv[0][0], t1b = acc[ai][0][m][1] + bv[0][1];
                    const f32x4 t2a = acc[ai][1][m][0] + bv[1][0], t2b = acc[ai][1][m][1] + bv[1][1];
                    float o1[8], o2[8];
                    o1[0] = t1a[0] * c0[0] - t2a[0] * c0[1]; o2[0] = t2a[0] * c0[0] + t1a[0] * c0[1];
                    o1[1] = t1a[1] * c0[2] - t2a[1] * c0[3]; o2[1] = t2a[1] * c0[2] + t1a[1] * c0[3];
                    o1[2] = t1a[2] * c1[0] - t2a[2] * c1[1]; o2[2] = t2a[2] * c1[0] + t1a[2] * c1[1];
                    o1[3] = t1a[3] * c1[2] - t2a[3] * c1[3]; o2[3] = t2a[3] * c1[2] + t1a[3] * c1[3];
                    o1[4] = t1b[0] * c2[0] - t2b[0] * c2[1]; o2[4] = t2b[0] * c2[0] + t1b[0] * c2[1];
                    o1[5] = t1b[1] * c2[2] - t2b[1] * c2[3]; o2[5] = t2b[1] * c2[2] + t1b[1] * c2[3];
                    o1[6] = t1b[2] * c3[0] - t2b[2] * c3[1]; o2[6] = t2b[2] * c3[0] + t1b[2] * c3[1];
                    o1[7] = t1b[3] * c3[2] - t2b[3] * c3[3]; o2[7] = t2b[3] * c3[2] + t1b[3] * c3[3];
                    u32x4 w1, w2;
                    w1.x = cvt_pk_bf16(o1[0], o1[1]); w1.y = cvt_pk_bf16(o1[2], o1[3]); w1.z = cvt_pk_bf16(o1[4], o1[5]); w1.w = cvt_pk_bf16(o1[6], o1[7]);
                    w2.x = cvt_pk_bf16(o2[0], o2[1]); w2.y = cvt_pk_bf16(o2[2], o2[3]); w2.z = cvt_pk_bf16(o2[4], o2[5]); w2.w = cvt_pk_bf16(o2[6], o2[7]);
                    bf16_t* rowp = dst + (size_t)row * pitch + head * HD + dlo;
                    *(u32x4*)(rowp) = w1; *(u32x4*)(rowp + 64) = w2;
                }
        } else {
            bf16_t* dst; int pitch, coff;
            if (vt < 5) { dst = (bf16_t*)(ws + WS_XR); pitch = DRNN; coff = vt * 256; }
            else if (vt < 10) { dst = (bf16_t*)(ws + WS_GR); pitch = DRNN; coff = (vt - 5) * 256; }
            else if (vt == 15) { dst = (bf16_t*)(ws + WS_V); pitch = DKV; coff = 0; }
            else if (vt < 20) { dst = (bf16_t*)(ws + WS_GA); pitch = DM; coff = (vt - 16) * 256; }
            else if (vt < 24) { dst = (bf16_t*)(ws + WS_MA); pitch = DM; coff = (vt - 20) * 256; }
            else { dst = (bf16_t*)(ws + WS_MR); pitch = DM; coff = (vt - 24) * 256; }
            const int col0 = coff + wc * 32 + 8 * fq;
#pragma unroll
            for (int ai = 0; ai < 2; ++ai)
#pragma unroll
                for (int m = 0; m < 4; ++m) { bf16_t* rowp = dst + (size_t)(row0 + ai * HALF + m * 16) * pitch + col0;
#pragma unroll
                    for (int bj = 0; bj < 2; ++bj) { const f32x4 v0 = acc[ai][bj][m][0] + bv[bj][0], v1 = acc[ai][bj][m][1] + bv[bj][1];
                        u32x4 w; w.x = cvt_pk_bf16(v0[0], v0[1]); w.y = cvt_pk_bf16(v0[2], v0[3]); w.z = cvt_pk_bf16(v1[0], v1[1]); w.w = cvt_pk_bf16(v1[2], v1[3]);
                        *(u32x4*)(rowp + bj * HALF) = w; } }
        }
    }
};
struct EpiBranchA {
    static constexpr bool PERM = true;
    const bf16* MA; float* TMP;
    __device__ __forceinline__ void operator()(const pg8::f32x4 (&acc)[2][2][4][2], const pg8::Unit& u, int wr, int wc, int fr, int fq) const {
        using namespace pg8;
        const int row0 = u.pm * BM + wr * 64 + fr, col0 = u.pn * BM + wc * 32 + 8 * fq;
#pragma unroll
        for (int ai = 0; ai < 2; ++ai)
#pragma unroll
            for (int m = 0; m < 4; ++m) { const size_t off = (size_t)(row0 + ai * HALF + m * 16) * DM + col0;
#pragma unroll
                for (int bj = 0; bj < 2; ++bj) { const u32x4 g = *(const u32x4*)(MA + off + bj * HALF);
                    const f32x4 a0 = acc[ai][bj][m][0], a1 = acc[ai][bj][m][1];
                    f32x4 o0, o1;
                    o0[0] = a0[0] * fast_sigmoid(bflo(g.x)); o0[1] = a0[1] * fast_sigmoid(bfhi(g.x)); o0[2] = a0[2] * fast_sigmoid(bflo(g.y)); o0[3] = a0[3] * fast_sigmoid(bfhi(g.y));
                    o1[0] = a1[0] * fast_sigmoid(bflo(g.z)); o1[1] = a1[1] * fast_sigmoid(bfhi(g.z)); o1[2] = a1[2] * fast_sigmoid(bflo(g.w)); o1[3] = a1[3] * fast_sigmoid(bfhi(g.w));
                    *(f32x4*)(TMP + off + bj * HALF) = o0; *(f32x4*)(TMP + off + bj * HALF + 4) = o1; } }
    }
};
struct EpiBranchR {
    static constexpr bool PERM = true;
    const bf16* MR; const float* TMP; bf16* MG;
    __device__ __forceinline__ void operator()(const pg8::f32x4 (&acc)[2][2][4][2], const pg8::Unit& u, int wr, int wc, int fr, int fq) const {
        using namespace pg8;
        const int row0 = u.pm * BM + wr * 64 + fr, col0 = u.pn * BM + wc * 32 + 8 * fq;
#pragma unroll
        for (int ai = 0; ai < 2; ++ai)
#pragma unroll
            for (int m = 0; m < 4; ++m) { const size_t off = (size_t)(row0 + ai * HALF + m * 16) * DM + col0;
#pragma unroll
                for (int bj = 0; bj < 2; ++bj) { const u32x4 g = *(const u32x4*)(MR + off + bj * HALF);
                    const f32x4 t0 = *(const f32x4*)(TMP + off + bj * HALF), t1 = *(const f32x4*)(TMP + off + bj * HALF + 4);
                    const f32x4 a0 = acc[ai][bj][m][0], a1 = acc[ai][bj][m][1];
                    f32x4 o0, o1;
                    o0[0] = t0[0] + a0[0] * fast_sigmoid(bflo(g.x)); o0[1] = t0[1] + a0[1] * fast_sigmoid(bfhi(g.x)); o0[2] = t0[2] + a0[2] * fast_sigmoid(bflo(g.y)); o0[3] = t0[3] + a0[3] * fast_sigmoid(bfhi(g.y));
                    o1[0] = t1[0] + a1[0] * fast_sigmoid(bflo(g.z)); o1[1] = t1[1] + a1[1] * fast_sigmoid(bfhi(g.z)); o1[2] = t1[2] + a1[2] * fast_sigmoid(bflo(g.w)); o1[3] = t1[3] + a1[3] * fast_sigmoid(bfhi(g.w));
                    u32x4 w; w.x = cvt_pk_bf16(o0[0], o0[1]); w.y = cvt_pk_bf16(o0[2], o0[3]); w.z = cvt_pk_bf16(o1[0], o1[1]); w.w = cvt_pk_bf16(o1[2], o1[3]);
                    *(u32x4*)(MG + off + bj * HALF) = w; } }
    }
};
struct EpiOut {
    static constexpr bool PERM = false;
    const float* x; const float* bias; float* out;
    __device__ __forceinline__ void operator()(const pg8::f32x4 (&acc)[2][2][4][2], const pg8::Unit& u, int wr, int wc, int fr, int fq) const {
        using namespace pg8;
        const int row0 = u.pm * BM + wr * 64 + fr, col0 = u.pn * BM + wc * 32 + 4 * fq;
        f32x4 bv[2][2];
#pragma unroll
        for (int bj = 0; bj < 2; ++bj)
#pragma unroll
            for (int n = 0; n < 2; ++n) bv[bj][n] = *(const f32x4*)(bias + col0 + bj * HALF + n * 16);
#pragma unroll
        for (int ai = 0; ai < 2; ++ai)
#pragma unroll
            for (int m = 0; m < 4; ++m) { const size_t off = (size_t)(row0 + ai * HALF + m * 16) * DM + col0;
#pragma unroll
                for (int bj = 0; bj < 2; ++bj)
#pragma unroll
                    for (int n = 0; n < 2; ++n) { const f32x4 xv = *(const f32x4*)(x + off + bj * HALF + n * 16);
                        *(f32x4*)(out + off + bj * HALF + n * 16) = xv * ALPHA + acc[ai][bj][m][n] + bv[bj][n]; } }
    }
};

constexpr int R_A_OFF = 0;
constexpr int R_XC_OFF = 16384;
constexpr int R_XC_PITCH = 132;
constexpr int R_ST_OFF = 16384 + 64 * R_XC_PITCH * 4;
static_assert(R_ST_OFF % 16 == 0 && R_ST_OFF + 3 * 16384 <= RING_BYTES, "rnn LDS map");

template <bool REV>
__device__ __forceinline__ void chunk_scan(const float (&a)[4][4], const float (&u)[4][4], float (&P)[4][4], float (&H)[4][4], int lane, float& Atot, float& Htot) {
    const int fq = lane >> 4, fr = lane & 15;
    const int g = REV ? 3 - fq : fq;
    const int src1 = REV ? ((lane + 16) & 63) : ((lane - 16) & 63);
    const int src2 = REV ? ((lane + 32) & 63) : ((lane - 32) & 63);
    const int srcT = REV ? fr : fr + 48;
    float Pc = 1.f, Hc = 0.f;
#pragma unroll
    for (int mm = 0; mm < 4; ++mm) {
        const int m = REV ? 3 - mm : mm;
        float p[4], h[4];
        if (!REV) { p[0] = a[m][0]; h[0] = u[m][0];
#pragma unroll
            for (int j = 1; j < 4; ++j) { p[j] = a[m][j] * p[j - 1]; h[j] = a[m][j] * h[j - 1] + u[m][j]; } }
        else { p[3] = a[m][3]; h[3] = u[m][3];
#pragma unroll
            for (int j = 2; j >= 0; --j) { p[j] = a[m][j] * p[j + 1]; h[j] = a[m][j] * h[j + 1] + u[m][j]; } }
        float Ag = REV ? p[0] : p[3], Hg = REV ? h[0] : h[3];
        { const float A1 = __shfl(Ag, src1), H1 = __shfl(Hg, src1); if (g >= 1) { Hg = Ag * H1 + Hg; Ag = Ag * A1; } }
        { const float A2 = __shfl(Ag, src2), H2 = __shfl(Hg, src2); if (g >= 2) { Hg = Ag * H2 + Hg; Ag = Ag * A2; } }
        float Ae = __shfl(Ag, src1), He = __shfl(Hg, src1); if (g == 0) { Ae = 1.f; He = 0.f; }
        const float At = __shfl(Ag, srcT), Ht = __shfl(Hg, srcT);
        const float Ps = Pc * Ae, Hs = Ae * Hc + He;
#pragma unroll
        for (int j = 0; j < 4; ++j) { P[m][j] = Ps * p[j]; H[m][j] = p[j] * Hs + h[j]; }
        Hc = At * Hc + Ht; Pc = Pc * At;
    }
    Atot = Pc; Htot = Hc;
}

__device__ __forceinline__ void rnn_local_phase(Frame& F) {
    using pg8::bf16x8; using pg8::f32x4;
    LAS unsigned char* lds = F.lds + RING_OFF;
    const bf16* XR = (const bf16*)(F.ws + WS_XR);
    const bf16* Wg_t = (const bf16*)(F.ws + WS_WG);
    bf16* HL = (bf16*)(F.ws + WS_HL); bf16* PF = (bf16*)(F.ws + WS_PF); bf16* PB = (bf16*)(F.ws + WS_PB);
    f32x2* AGG = (f32x2*)(F.ws + WS_AGG);
    const int tid = F.tid, lane = F.lane, w = F.wave, fr = lane & 15, fq = lane >> 4;
    constexpr int NUNITS = BATCH * NCH * NRB;
    for (int un = F.vcu; un < NUNITS; un += F.G) {
        const int cb = un % NRB, bj = un / NRB, b = bj / NCH, j = bj % NCH;
        const int t0 = b * SEQ + j * LCH;
        {
            const int tt = tid >> 3, cg = tid & 7;
            const int s = j * LCH + tt;
#pragma unroll
            for (int h = 0; h < 2; ++h) {
                const int cl = cg * 16 + h * 8, c = cb * 128 + cl;
                float y[8];
                { const f32x4 b0 = *(const f32x4*)(F.conv_b + c), b1 = *(const f32x4*)(F.conv_b + c + 4);
                  y[0] = b0[0]; y[1] = b0[1]; y[2] = b0[2]; y[3] = b0[3]; y[4] = b1[0]; y[5] = b1[1]; y[6] = b1[2]; y[7] = b1[3]; }
#pragma unroll
                for (int jj = 0; jj < 4; ++jj) {
                    const int sp = s + jj - 2;
                    if (sp >= 0 && sp < SEQ) {
                        const v4u xv = *(const GAS v4u*)(XR + (size_t)(b * SEQ + sp) * DRNN + c);
                        const f32x4 w0 = *(const f32x4*)(F.conv_w + jj * DRNN + c), w1 = *(const f32x4*)(F.conv_w + jj * DRNN + c + 4);
                        y[0] += w0[0] * bflo(xv.x); y[1] += w0[1] * bfhi(xv.x); y[2] += w0[2] * bflo(xv.y); y[3] += w0[3] * bfhi(xv.y);
                        y[4] += w1[0] * bflo(xv.z); y[5] += w1[1] * bfhi(xv.z); y[6] += w1[2] * bflo(xv.w); y[7] += w1[3] * bfhi(xv.w);
                    }
                }
                LAS float* xc = (LAS float*)(lds + R_XC_OFF) + tt * R_XC_PITCH + cl;
                *(LAS f32x4*)(xc) = (f32x4){y[0], y[1], y[2], y[3]}; *(LAS f32x4*)(xc + 4) = (f32x4){y[4], y[5], y[6], y[7]};
                v4u o; o.x = pk2(y[0], y[1]); o.y = pk2(y[2], y[3]); o.z = pk2(y[4], y[5]); o.w = pk2(y[6], y[7]);
                const int chunk = (cl >> 3) ^ (tt & 15);
                *(LAS v4u*)(lds + R_A_OFF + tt * 256 + chunk * 16) = o;
            }
        }
        __syncthreads();
        const int nl = 16 * w + fr;
        const int c = cb * 128 + nl;
        float xcv[4][4];
#pragma unroll
        for (int m = 0; m < 4; ++m)
#pragma unroll
            for (int r = 0; r < 4; ++r) xcv[m][r] = *((const LAS float*)(lds + R_XC_OFF) + (16 * m + 4 * fq + r) * R_XC_PITCH + nl);
        float hsum[4][4];
#pragma unroll
        for (int dir = 0; dir < 2; ++dir) {
            f32x4 accr[4], acci[4];
#pragma unroll
            for (int m = 0; m < 4; ++m) { accr[m] = (f32x4){0.f, 0.f, 0.f, 0.f}; acci[m] = (f32x4){0.f, 0.f, 0.f, 0.f}; }
            const bf16* wr_ = Wg_t + (size_t)((0 * 2 + dir) * NRB + cb) * 16384 + (size_t)nl * 128 + 8 * fq;
            const bf16* wi_ = Wg_t + (size_t)((1 * 2 + dir) * NRB + cb) * 16384 + (size_t)nl * 128 + 8 * fq;
            bf16x8 br[4], bi[4];
#pragma unroll
            for (int ks = 0; ks < 4; ++ks) { br[ks] = *(const GAS bf16x8*)(wr_ + 32 * ks); bi[ks] = *(const GAS bf16x8*)(wi_ + 32 * ks); }
#pragma unroll
            for (int m = 0; m < 4; ++m)
#pragma unroll
                for (int ks = 0; ks < 4; ++ks) {
                    const bf16x8 af = *(const LAS bf16x8*)(lds + R_A_OFF + (16 * m + fr) * 256 + (((4 * ks + fq) ^ fr) << 4));
                    accr[m] = __builtin_amdgcn_mfma_f32_16x16x32_bf16(af, br[ks], accr[m], 0, 0, 0);
                    acci[m] = __builtin_amdgcn_mfma_f32_16x16x32_bf16(af, bi[ks], acci[m], 0, 0, 0);
                }
            const float ba = F.lru_ba[dir * DRNN + c], bx = F.lru_bx[dir * DRNN + c], lm = F.lam[dir * DRNN + c];
            const float sp = fmaxf(-lm, 0.f) + log1pf(expf(-fabsf(lm)));
            const float kap = -8.0f * sp * LOG2E;
            float av[4][4], uv[4][4];
#pragma unroll
            for (int m = 0; m < 4; ++m)
#pragma unroll
                for (int r = 0; r < 4; ++r) {
                    const float rg = fast_sigmoid(accr[m][r] + ba);
                    const float ig = fast_sigmoid(acci[m][r] + bx);
                    const float l2a = kap * rg;
                    const float a = __builtin_amdgcn_exp2f(l2a);
                    const float y = l2a * (2.0f * 0.6931471805599453f);
                    const float ser = -y * (1.0f + y * (0.5f + y * (0.16666667f + y * (0.041666668f + y * 0.008333334f))));
                    const float om = (y > -0.25f) ? ser : (1.0f - a * a);
                    av[m][r] = a; uv[m][r] = __builtin_amdgcn_sqrtf(om) * (ig * xcv[m][r]);
                }
            float Pv[4][4], Hv[4][4]; float At, Ht;
            if (dir == 0) chunk_scan<false>(av, uv, Pv, Hv, lane, At, Ht); else chunk_scan<true>(av, uv, Pv, Hv, lane, At, Ht);
            if (fq == 0) AGG[((size_t)(b * NCH + j) * 2 + dir) * DRNN + c] = (f32x2){At, Ht};
            LAS bf16* stP = (LAS bf16*)(lds + R_ST_OFF + (dir == 0 ? 16384 : 32768));
#pragma unroll
            for (int m = 0; m < 4; ++m)
#pragma unroll
                for (int r = 0; r < 4; ++r) {
                    stP[(16 * m + 4 * fq + r) * 128 + nl] = (bf16)f2bf(Pv[m][r]);
                    if (dir == 0) hsum[m][r] = Hv[m][r]; else hsum[m][r] += Hv[m][r];
                }
        }
        { LAS bf16* stH = (LAS bf16*)(lds + R_ST_OFF);
#pragma unroll
          for (int m = 0; m < 4; ++m)
#pragma unroll
              for (int r = 0; r < 4; ++r) stH[(16 * m + 4 * fq + r) * 128 + nl] = (bf16)f2bf(hsum[m][r]); }
        __syncthreads();
#pragma unroll
        for (int arr = 0; arr < 3; ++arr) {
            bf16* dst = arr == 0 ? HL : (arr == 1 ? PF : PB);
#pragma unroll
            for (int k = 0; k < 2; ++k) { const int idx = tid + 512 * k, tok = idx >> 4, ch = idx & 15;
                const v4u v = *(const LAS v4u*)(lds + R_ST_OFF + arr * 16384 + tok * 256 + ch * 16);
                *(GAS v4u*)(dst + (size_t)(t0 + tok) * DRNN + cb * 128 + ch * 8) = v; }
        }
    }
    __syncthreads();
}

__device__ __forceinline__ void carry_phase(Frame& F) {
    const f32x2* AGG = (const f32x2*)(F.ws + WS_AGG);
    float* CAR = (float*)(F.ws + WS_CAR);
    const int gw = F.vcu * NWAVES + F.wave, NGW = F.G * NWAVES;
    constexpr int NTASK = BATCH * 2 * (DRNN / 64);
    for (int task = gw; task < NTASK; task += NGW) {
        const int cg = task % (DRNN / 64), bd = task / (DRNN / 64), dir = bd & 1, b = bd >> 1;
        const int c = cg * 64 + F.lane;
        float carry = 0.f;
        for (int jb = 0; jb < NCH; jb += 8) {
            f32x2 ah[8];
#pragma unroll
            for (int k = 0; k < 8; ++k) { const int j = dir == 0 ? jb + k : NCH - 1 - (jb + k); ah[k] = *(const GAS f32x2*)(AGG + ((size_t)(b * NCH + j) * 2 + dir) * DRNN + c); }
#pragma unroll
            for (int k = 0; k < 8; ++k) { const int j = dir == 0 ? jb + k : NCH - 1 - (jb + k);
                CAR[((size_t)(b * NCH + j) * 2 + dir) * DRNN + c] = carry; carry = ah[k].x * carry + ah[k].y; }
        }
    }
}

__device__ __forceinline__ void fixup_phase(Frame& F) {
    bf16* HL = (bf16*)(F.ws + WS_HL); const bf16* PF = (const bf16*)(F.ws + WS_PF); const bf16* PB = (const bf16*)(F.ws + WS_PB); const bf16* GR = (const bf16*)(F.ws + WS_GR);
    const float* CAR = (const float*)(F.ws + WS_CAR);
    const int gt = F.vcu * (NWAVES * 64) + F.tid, NGT = F.G * NWAVES * 64;
    constexpr int CPR = DRNN / 8;
    for (int it = gt; it < T * CPR; it += NGT) {
        const int t = it / CPR, c = (it % CPR) * 8;
        const int b = t / SEQ, j = (t % SEQ) / LCH;
        const size_t off = (size_t)t * DRNN + c;
        const v4u h = *(const GAS v4u*)(HL + off), pf = *(const GAS v4u*)(PF + off), pb = *(const GAS v4u*)(PB + off), g = *(const GAS v4u*)(GR + off);
        const float* cfp = CAR + ((size_t)(b * NCH + j) * 2 + 0) * DRNN + c; const float* cbp = cfp + DRNN;
        const f32x4 cf0 = *(const GAS f32x4*)(cfp), cf1 = *(const GAS f32x4*)(cfp + 4), cb0 = *(const GAS f32x4*)(cbp), cb1 = *(const GAS f32x4*)(cbp + 4);
        float o[8];
        o[0] = (bflo(h.x) + bflo(pf.x) * cf0[0] + bflo(pb.x) * cb0[0]) * fast_silu(bflo(g.x));
        o[1] = (bfhi(h.x) + bfhi(pf.x) * cf0[1] + bfhi(pb.x) * cb0[1]) * fast_silu(bfhi(g.x));
        o[2] = (bflo(h.y) + bflo(pf.y) * cf0[2] + bflo(pb.y) * cb0[2]) * fast_silu(bflo(g.y));
        o[3] = (bfhi(h.y) + bfhi(pf.y) * cf0[3] + bfhi(pb.y) * cb0[3]) * fast_silu(bfhi(g.y));
        o[4] = (bflo(h.z) + bflo(pf.z) * cf1[0] + bflo(pb.z) * cb1[0]) * fast_silu(bflo(g.z));
        o[5] = (bfhi(h.z) + bfhi(pf.z) * cf1[1] + bfhi(pb.z) * cb1[1]) * fast_silu(bfhi(g.z));
        o[6] = (bflo(h.w) + bflo(pf.w) * cf1[2] + bflo(pb.w) * cb1[2]) * fast_silu(bflo(g.w));
        o[7] = (bfhi(h.w) + bfhi(pf.w) * cf1[3] + bfhi(pb.w) * cb1[3]) * fast_silu(bfhi(g.w));
        v4u ov; ov.x = pk2(o[0], o[1]); ov.y = pk2(o[2], o[3]); ov.z = pk2(o[4], o[5]); ov.w = pk2(o[6], o[7]);
        *(GAS v4u*)(HL + off) = ov;
    }
}

namespace att {
using bf16x8 = __attribute__((ext_vector_type(8))) short;
using s16x4  = __attribute__((ext_vector_type(4))) short;
using f32x16 = __attribute__((ext_vector_type(16))) float;
using u32x4  = __attribute__((ext_vector_type(4))) unsigned;
constexpr int D = 128, NW = 8, QBLK = 32, KVBLK = 64, NT = 6;
constexpr int LDQ = DM, LDK = DKV;
constexpr float THR = 8.f;
constexpr size_t SHM_V = KVBLK * D * 2, SHM_K = KVBLK * D * 2, SHM_ATTN = 2 * SHM_V + 2 * SHM_K + NW * 64 * 4;
constexpr float NEG = -1e30f;
#define KSWZ(row, colB) ((row) * 256 + ((colB) ^ (((row) & 7) << 4)))
#define SBAR() __builtin_amdgcn_sched_barrier(0)
__device__ __forceinline__ int crow(int r, int hi) { return (r & 3) + 8 * (r >> 2) + 4 * hi; }
__device__ __forceinline__ unsigned cvtpk(float lo, float hi) { unsigned r; asm volatile("v_cvt_pk_bf16_f32 %0, %1, %2" : "=v"(r) : "v"(lo), "v"(hi)); return r; }

__device__ __forceinline__ void partialSM(f32x16& p0, f32x16& p1, float& m_reg, float& mn, float& alpha) {
  constexpr float C = SM_SCALE * LOG2E;
  float pmax = p0[0]; for (int r = 1; r < 16; ++r) pmax = fmaxf(pmax, p0[r]); for (int r = 0; r < 16; ++r) pmax = fmaxf(pmax, p1[r]);
  { auto rr = __builtin_amdgcn_permlane32_swap(__float_as_uint(pmax), __float_as_uint(pmax), false, false);
    pmax = fmaxf(__uint_as_float(rr[0]), __uint_as_float(rr[1])); }
  if (__builtin_expect(__all(pmax - m_reg <= THR / SM_SCALE), 1)) { mn = m_reg; alpha = 1.f; }
  else { mn = fmaxf(m_reg, pmax); alpha = __builtin_amdgcn_exp2f((m_reg - mn) * C); m_reg = mn; }
  float mnC = -mn * C;
  for (int r = 0; r < 16; ++r) p0[r] = fmaf(p0[r], C, mnC); for (int r = 0; r < 16; ++r) p1[r] = fmaf(p1[r], C, mnC);
  for (int r = 0; r < 16; ++r) p0[r] = __builtin_amdgcn_exp2f(p0[r]);
}
__device__ __forceinline__ void finishSM(f32x16& p0, f32x16& p1, float alpha, float& l_reg, bf16x8& pa0, bf16x8& pa1, bf16x8& pa2, bf16x8& pa3) {
  for (int r = 0; r < 16; ++r) p1[r] = __builtin_amdgcn_exp2f(p1[r]);
  float ps = 0; for (int r = 0; r < 16; ++r) ps += p0[r]; for (int r = 0; r < 16; ++r) ps += p1[r];
  { auto rr = __builtin_amdgcn_permlane32_swap(__float_as_uint(ps), __float_as_uint(ps), false, false);
    ps = __uint_as_float(rr[0]) + __uint_as_float(rr[1]); }
  l_reg = l_reg * alpha + ps;
#define PK4(P, BASE, OUT) do { unsigned a0 = cvtpk(P[BASE + 0], P[BASE + 1]), a1 = cvtpk(P[BASE + 2], P[BASE + 3]);   \
    unsigned b0 = cvtpk(P[BASE + 4], P[BASE + 5]), b1 = cvtpk(P[BASE + 6], P[BASE + 7]);                              \
    auto r0 = __builtin_amdgcn_permlane32_swap(a0, b0, false, false); auto r1 = __builtin_amdgcn_permlane32_swap(a1, b1, false, false); \
    u32x4 w = {r0[0], r1[0], r0[1], r1[1]}; OUT = *reinterpret_cast<bf16x8*>(&w); } while (0)
  PK4(p0, 0, pa0); PK4(p0, 8, pa1); PK4(p1, 0, pa2); PK4(p1, 8, pa3);
#undef PK4
}
__device__ __forceinline__ void qkt(f32x16& p0, f32x16& p1, const unsigned short* Ks, const bf16x8* qr, int r32, int hi) {
  p0 = f32x16{}; p1 = f32x16{};
  for (int d0 = 0; d0 < 8; ++d0) { int cb = (d0 * 16 + hi * 8) * 2;
    bf16x8 b0 = *reinterpret_cast<const bf16x8*>((const char*)Ks + KSWZ(r32, cb));
    bf16x8 b1 = *reinterpret_cast<const bf16x8*>((const char*)Ks + KSWZ(32 + r32, cb));
    p0 = __builtin_amdgcn_mfma_f32_32x32x16_bf16(b0, qr[d0], p0, 0, 0, 0);
    p1 = __builtin_amdgcn_mfma_f32_32x32x16_bf16(b1, qr[d0], p1, 0, 0, 0); }
}
__device__ __forceinline__ int v_st(int k, int c) { const int kk = (k & ~0xC) | ((k & 4) << 1) | ((k & 8) >> 1); return ((kk >> 3) * 4 + (c >> 5)) * 512 + ((kk & 7) * 32 + (c & 31)) * 2; }
__device__ __forceinline__ int v_rd_base(int lane) { return ((lane & 3) << 3) | (((lane >> 2) & 3) << 6) | (((lane >> 4) & 1) << 5) | (((lane >> 5) & 1) << 8); }
constexpr int v_rd_off(int d0, int ks, int half) { return d0 * 512 + ks * 4096 + half * 2048; }
template <int OFF> __device__ __forceinline__ s16x4 tr_read(int vb) {
  s16x4 r; asm volatile("ds_read_b64_tr_b16 %0, %1 offset:%2" : "=&v"(r) : "v"(vb), "i"(OFF) : "memory"); return r;
}
template <int D0> __device__ __forceinline__ void pv_one(f32x16& od, int vb, bf16x8 pa0, bf16x8 pa1, bf16x8 pa2, bf16x8 pa3) {
  const s16x4 l0 = tr_read<v_rd_off(D0, 0, 0)>(vb), h0 = tr_read<v_rd_off(D0, 0, 1)>(vb), l1 = tr_read<v_rd_off(D0, 1, 0)>(vb), h1 = tr_read<v_rd_off(D0, 1, 1)>(vb);
  const s16x4 l2 = tr_read<v_rd_off(D0, 2, 0)>(vb), h2 = tr_read<v_rd_off(D0, 2, 1)>(vb), l3 = tr_read<v_rd_off(D0, 3, 0)>(vb), h3 = tr_read<v_rd_off(D0, 3, 1)>(vb);
  asm volatile("s_waitcnt lgkmcnt(0)" ::: "memory"); SBAR();
#define PK(L, H) (bf16x8){L[0], L[1], L[2], L[3], H[0], H[1], H[2], H[3]}
  od = __builtin_amdgcn_mfma_f32_32x32x16_bf16(pa0, PK(l0, h0), od, 0, 0, 0);
  od = __builtin_amdgcn_mfma_f32_32x32x16_bf16(pa1, PK(l1, h1), od, 0, 0, 0);
  od = __builtin_amdgcn_mfma_f32_32x32x16_bf16(pa2, PK(l2, h2), od, 0, 0, 0);
  od = __builtin_amdgcn_mfma_f32_32x32x16_bf16(pa3, PK(l3, h3), od, 0, 0, 0);
#undef PK
}
__device__ __forceinline__ void pv_d0(f32x16* o, int vb, bf16x8 pa0, bf16x8 pa1, bf16x8 pa2, bf16x8 pa3) {
  pv_one<0>(o[0], vb, pa0, pa1, pa2, pa3); pv_one<1>(o[1], vb, pa0, pa1, pa2, pa3); pv_one<2>(o[2], vb, pa0, pa1, pa2, pa3); pv_one<3>(o[3], vb, pa0, pa1, pa2, pa3);
}
__device__ __forceinline__ void band_mask(f32x16& p0, f32x16& p1, int kt0, int qpos, int qw0, int hi) {
  const bool full = (kt0 >= 0) && (kt0 + 63 < SEQ) && (kt0 >= qw0 + 31 - 128) && (kt0 + 63 <= qw0 + 128);
  if (full) return;
#pragma unroll
  for (int r = 0; r < 16; ++r) {
    const int k0 = kt0 + crow(r, hi), k1 = k0 + 32;
    const int d0 = qpos - k0, d1 = qpos - k1;
    const bool v0 = (k0 >= 0) && (k0 < SEQ) && (d0 <= 128) && (d0 >= -128);
    const bool v1 = (k1 >= 0) && (k1 < SEQ) && (d1 <= 128) && (d1 >= -128);
    p0[r] = v0 ? p0[r] : NEG; p1[r] = v1 ? p1[r] : NEG;
  }
}

__device__ __forceinline__ void attn_unit(int b, int hp, int qb, unsigned short* Qm, const unsigned short* __restrict__ Km, const unsigned short* __restrict__ Vm,
                                          const unsigned short* __restrict__ GA, const float* __restrict__ sink, char* lds) {
  const int tid = threadIdx.x, wid = __builtin_amdgcn_readfirstlane(tid >> 6), lane = tid & 63, r32 = lane & 31, hi = lane >> 5;
  unsigned short* V_lds = (unsigned short*)lds; unsigned short* K_lds = (unsigned short*)(lds + 2 * SHM_V);
  float* ws = (float*)(lds + 2 * SHM_V + 2 * SHM_K) + wid * 64; float* li_l = ws; float* al_l = ws + 32;
  const int head = 2 * hp + (wid >> 2), kvh = hp >> 1;
  const int q0 = qb * 128, qw0 = q0 + 32 * (wid & 3), qpos = qw0 + r32;
  const long rowbase = (long)b * SEQ;
  float m_reg = sink[head] * (1.0f / SM_SCALE), l_reg = 1.f; f32x16 o[4] = {}; bf16x8 qr[8];
  unsigned short* Qw = Qm + (rowbase + qw0) * LDQ + head * D;
#pragma unroll
  for (int d0 = 0; d0 < 8; ++d0) qr[d0] = *reinterpret_cast<const bf16x8*>(Qw + (long)r32 * LDQ + d0 * 16 + hi * 8);
  const int sr = tid >> 4, sc = (tid & 15) * 8, vst0 = v_st(sr, sc), vst1 = v_st(32 + sr, sc);
  const int vb0 = (int)(uintptr_t)V_lds + v_rd_base(lane);
  const unsigned short* Kh = Km + rowbase * LDK + kvh * D; const unsigned short* Vh = Vm + rowbase * LDK + kvh * D;
  struct { bf16x8 vs0, vs1, ks0, ks1; } sr_[2];
#define TROW(tt) (min(max(q0 - 128 + 64 * (tt), 0), SEQ - 64))
#define SLOAD(i, tt) do { const long k0_ = TROW(tt); sr_[i].vs0 = *reinterpret_cast<const bf16x8*>(&Vh[(k0_ + sr) * LDK + sc]); sr_[i].vs1 = *reinterpret_cast<const bf16x8*>(&Vh[(k0_ + 32 + sr) * LDK + sc]); \
    sr_[i].ks0 = *reinterpret_cast<const bf16x8*>(&Kh[(k0_ + sr) * LDK + sc]); sr_[i].ks1 = *reinterpret_cast<const bf16x8*>(&Kh[(k0_ + 32 + sr) * LDK + sc]); } while (0)
#define SWRITE(bb, i) do { *(bf16x8*)((char*)V_lds + (bb) * SHM_V + vst0) = sr_[i].vs0;          \
    *(bf16x8*)((char*)V_lds + (bb) * SHM_V + vst1) = sr_[i].vs1; int kc = sc * 2;               \
    *(bf16x8*)((char*)K_lds + (bb) * SHM_K + KSWZ(sr, kc)) = sr_[i].ks0;                       \
    *(bf16x8*)((char*)K_lds + (bb) * SHM_K + KSWZ(32 + sr, kc)) = sr_[i].ks1; } while (0)
#define SWAIT() asm volatile("s_waitcnt vmcnt(4)" ::: "memory")
#define RESC(a) do { if (__any((a) < 1.f)) { if (hi == 0) al_l[r32] = (a); asm volatile("s_waitcnt lgkmcnt(0)" ::: "memory"); \
    for (int d = 0; d < 4; ++d) for (int r = 0; r < 16; ++r) o[d][r] *= al_l[crow(r, hi)]; } } while (0)
#define KT0(tt) (q0 - 128 + 64 * (tt))
  f32x16 pA0, pA1, pB0, pB1; float mnA, mnB, alA, alB; bf16x8 pa0, pa1, pa2, pa3;
  constexpr int SE = 0, SO = 1;
  __syncthreads();
  SLOAD(SE, 0); asm volatile("s_waitcnt vmcnt(0)" ::: "memory"); SWRITE(0, SE); __syncthreads();
  qkt(pA0, pA1, K_lds, qr, r32, hi); band_mask(pA0, pA1, KT0(0), qpos, qw0, hi); partialSM(pA0, pA1, m_reg, mnA, alA);
  SLOAD(SO, 1); SLOAD(SE, 2);
  SWAIT(); SWRITE(1, SO); __syncthreads();
#pragma unroll 1
  for (int j = 1; j + 1 < NT; j += 2) {
    SBAR(); qkt(pB0, pB1, (unsigned short*)((char*)K_lds + SHM_K), qr, r32, hi); band_mask(pB0, pB1, KT0(j), qpos, qw0, hi);
    finishSM(pA0, pA1, alA, l_reg, pa0, pa1, pa2, pa3); SBAR();
    SLOAD(SO, j + 2); SBAR();
    pv_d0(o, vb0, pa0, pa1, pa2, pa3); partialSM(pB0, pB1, m_reg, mnB, alB);
    __syncthreads(); SWAIT(); SWRITE(0, SE);
    RESC(alB); __syncthreads();
    SBAR(); qkt(pA0, pA1, K_lds, qr, r32, hi); band_mask(pA0, pA1, KT0(j + 1), qpos, qw0, hi);
    finishSM(pB0, pB1, alB, l_reg, pa0, pa1, pa2, pa3); SBAR();
    if (j + 3 < NT) SLOAD(SE, j + 3); SBAR();
    pv_d0(o, vb0 + (int)SHM_V, pa0, pa1, pa2, pa3); partialSM(pA0, pA1, m_reg, mnA, alA);
    __syncthreads(); SWAIT(); SWRITE(1, SO);
    RESC(alA); __syncthreads();
  }
  SBAR(); qkt(pB0, pB1, (unsigned short*)((char*)K_lds + SHM_K), qr, r32, hi); band_mask(pB0, pB1, KT0(NT - 1), qpos, qw0, hi);
  finishSM(pA0, pA1, alA, l_reg, pa0, pa1, pa2, pa3); SBAR();
  pv_d0(o, vb0, pa0, pa1, pa2, pa3); partialSM(pB0, pB1, m_reg, mnB, alB);
  __syncthreads(); RESC(alB);
  finishSM(pB0, pB1, alB, l_reg, pa0, pa1, pa2, pa3); SBAR();
  pv_d0(o, vb0 + (int)SHM_V, pa0, pa1, pa2, pa3);
  if (hi == 0) li_l[r32] = l_reg; asm volatile("s_waitcnt lgkmcnt(0)" ::: "memory");
  float rli[16];
#pragma unroll
  for (int r = 0; r < 16; ++r) rli[r] = __builtin_amdgcn_rcpf(li_l[crow(r, hi)]);
  __syncthreads();
  unsigned short* stg = (unsigned short*)(lds + wid * 8192);
#pragma unroll
  for (int r = 0; r < 16; ++r) { const int orow = crow(r, hi);
#pragma unroll
    for (int d0 = 0; d0 < 4; ++d0) stg[orow * 128 + d0 * 32 + r32] = (unsigned short)f2bf(o[d0][r] * rli[r]); }
  asm volatile("s_waitcnt lgkmcnt(0)" ::: "memory");
  const unsigned short* Gw = GA + (rowbase + qw0) * LDQ + head * D;
#pragma unroll
  for (int i = 0; i < 8; ++i) { const int row = i * 4 + (lane >> 4), ch = lane & 15;
    const u32x4 ov = *(const u32x4*)(stg + row * 128 + ch * 8);
    const u32x4 gv = *(const u32x4*)(Gw + (long)row * LDQ + ch * 8);
    u32x4 w;
    w.x = pk2(bflo(ov.x) * fast_silu(bflo(gv.x)), bfhi(ov.x) * fast_silu(bfhi(gv.x)));
    w.y = pk2(bflo(ov.y) * fast_silu(bflo(gv.y)), bfhi(ov.y) * fast_silu(bfhi(gv.y)));
    w.z = pk2(bflo(ov.z) * fast_silu(bflo(gv.z)), bfhi(ov.z) * fast_silu(bfhi(gv.z)));
    w.w = pk2(bflo(ov.w) * fast_silu(bflo(gv.w)), bfhi(ov.w) * fast_silu(bfhi(gv.w)));
    *(u32x4*)(Qw + (long)row * LDQ + ch * 8) = w; }
#undef TROW
#undef SLOAD
#undef SWRITE
#undef SWAIT
#undef RESC
#undef KT0
}
#undef SBAR
#undef KSWZ
}

__device__ __forceinline__ void attn_phase(Frame& F, char* lds) {
    unsigned short* Q = (unsigned short*)(F.ws + WS_Q); const unsigned short* K = (const unsigned short*)(F.ws + WS_K); const unsigned short* V = (const unsigned short*)(F.ws + WS_V);
    const unsigned short* GA = (const unsigned short*)(F.ws + WS_GA);
    constexpr int NUNITS = BATCH * 128 * 4;
    for (int un = F.vcu; un < NUNITS; un += F.G) {
        const int hp = un & 3, qb = (un >> 2) & 127, b = un >> 9;
        att::attn_unit(b, hp, qb, Q, K, V, GA, F.sink, lds);
    }
    __syncthreads();
}

__device__ __forceinline__ float wave_sum(float v) {
#pragma unroll
    for (int o = 1; o < 64; o <<= 1) v += __shfl_xor(v, o);
    return v;
}
__device__ __forceinline__ void ln_phase(Frame& F) {
    const int gw = F.vcu * NWAVES + F.wave, NGW = F.G * NWAVES;
    f32x4 gv[4], bv[4];
#pragma unroll
    for (int jj = 0; jj < 4; ++jj) { gv[jj] = *(const GAS f32x4*)(F.ln_g + 4 * F.lane + 256 * jj); bv[jj] = *(const GAS f32x4*)(F.ln_b + 4 * F.lane + 256 * jj); }
    for (int m = gw; m < T; m += NGW) {
        GAS f32x4* xr = (GAS f32x4*)(F.out + (size_t)m * DM) + F.lane;
        f32x4 v[4]; float s = 0.f;
#pragma unroll
        for (int jj = 0; jj < 4; ++jj) { v[jj] = xr[64 * jj]; s += (v[jj].x + v[jj].y) + (v[jj].z + v[jj].w); }
        const float mean = wave_sum(s) * (1.f / DM); float s2 = 0.f;
#pragma unroll
        for (int jj = 0; jj < 4; ++jj) { v[jj] = v[jj] - mean; s2 += (v[jj].x * v[jj].x + v[jj].y * v[jj].y) + (v[jj].z * v[jj].z + v[jj].w * v[jj].w); }
        const float rstd = 1.f / sqrtf(wave_sum(s2) * (1.f / DM) + LN_EPS);
#pragma unroll
        for (int jj = 0; jj < 4; ++jj) xr[64 * jj] = v[jj] * rstd * gv[jj] + bv[jj];
    }
}

struct Args { const float* in[17]; float* out; unsigned char* ws; int ph_lo, ph_hi, li, pad; };
__global__ void __launch_bounds__(NWAVES * 64, 2) mk_fwd(Args args) {
    extern __shared__ __attribute__((aligned(16))) unsigned char lds[];
    Frame F;
    F.lds = (LAS unsigned char*)lds;
    F.MISC = (volatile LAS unsigned*)(F.lds + MISC_OFF);
    F.tid = threadIdx.x; F.lane = F.tid & 63; F.wave = __builtin_amdgcn_readfirstlane(F.tid >> 6);
    F.G = gridDim.x; { const int bx = blockIdx.x; F.vcu = (F.G % 8 == 0) ? (bx % 8) * (F.G / 8) + bx / 8 : bx; }
    F.ws = args.ws; F.ctl = (gu32*)(args.ws + WS_CTL);
    F.x = args.in[0]; F.w_in = args.in[1]; F.b_in = args.in[2]; F.sink = args.in[3]; F.conv_w = args.in[4]; F.conv_b = args.in[5];
    F.lru_wa = args.in[6]; F.lru_ba = args.in[7]; F.lru_wx = args.in[8]; F.lru_bx = args.in[9]; F.lam = args.in[10];
    F.w_ba = args.in[11]; F.w_br = args.in[12]; F.w_out = args.in[13]; F.b_out = args.in[14]; F.ln_g = args.in[15]; F.ln_b = args.in[16];
    F.out = args.out;
    for (int u = F.tid; u < (LDS_BYTES - LDSCTL_OFF) / 4; u += NWAVES * 64) ((LAS unsigned*)(F.lds + LDSCTL_OFF))[u] = 0u;
    __syncthreads();
    XcdBarrier bar; bar.bar = (unsigned*)(F.ctl + CW_BAR); bar.x = 0; bar.st = nullptr;
    if (N_LAUNCHES == 1) bar = xcd_barrier_post((unsigned*)(F.ctl + CW_BAR), F.MISC + 8);
#define GRID_BAR() do { if (N_LAUNCHES == 1) xcd_barrier(bar); } while (0)
    const int lo = args.ph_lo, hi = args.ph_hi;
#define IN(k) (lo <= (k) && (k) < hi)
#define BOTH(k) (IN(k) && IN((k) + 1))

    if (IN(0)) { p0_prologue(F); if (BOTH(0)) GRID_BAR(); }
    if (IN(1)) {
        pg8::Gemm g{(const bf16*)F.out, (const bf16*)(F.ws + WS_WIN), DM, DM, T, 2560, DM}; pg8::StaticOrder S; S.init(T, 2560, F.G, (int)blockIdx.x);
        EpiProj E{F.ws, (const float*)(F.ws + WS_BIAS), 0};
        pg8::gemm_phase<EpiProj, pg8::StaticOrder, true, true>(F.lds + RING_OFF, g, S, E);
        if (BOTH(1)) GRID_BAR();
    }
    if (IN(2)) { rnn_local_phase(F); if (BOTH(2)) GRID_BAR(); }
    if (IN(3)) { carry_phase(F); if (BOTH(3)) GRID_BAR(); }
    if (IN(4)) { fixup_phase(F); if (BOTH(4)) GRID_BAR(); }
    if (IN(5)) {
        pg8::Gemm g{(const bf16*)F.out, (const bf16*)(F.ws + WS_WIN) + (size_t)2560 * DM, DM, DM, T, 4608, DM}; pg8::StaticOrder S; S.init(T, 4608, F.G, (int)blockIdx.x);
        EpiProj E{F.ws, (const float*)(F.ws + WS_BIAS), 10};
        pg8::gemm_phase<EpiProj, pg8::StaticOrder, true, true>(F.lds + RING_OFF, g, S, E);
        if (BOTH(5)) GRID_BAR();
    }
    if (IN(6)) { attn_phase(F, (char*)lds + RING_OFF); if (BOTH(6)) GRID_BAR(); }
    if (IN(7)) {
        { pg8::Gemm g{(const bf16*)(F.ws + WS_Q), (const bf16*)(F.ws + WS_WA), DM, DM, T, DM, DM}; pg8::StaticOrder S; S.init(T, DM, F.G, (int)blockIdx.x);
          EpiBranchA E{(const bf16*)(F.ws + WS_MA), F.out};
          pg8::gemm_phase<EpiBranchA, pg8::StaticOrder, true, true>(F.lds + RING_OFF, g, S, E); }
        { pg8::Gemm g{(const bf16*)(F.ws + WS_HL), (const bf16*)(F.ws + WS_WR), DRNN, DRNN, T, DM, DRNN}; pg8::StaticOrder S; S.init(T, DM, F.G, (int)blockIdx.x);
          EpiBranchR E{(const bf16*)(F.ws + WS_MR), F.out, (bf16*)(F.ws + WS_MG)};
          pg8::gemm_phase<EpiBranchR, pg8::StaticOrder, true, true>(F.lds + RING_OFF, g, S, E); }
        if (BOTH(7)) GRID_BAR();
    }
    if (IN(8)) {
        pg8::Gemm g{(const bf16*)(F.ws + WS_MG), (const bf16*)(F.ws + WS_WO), DM, DM, T, DM, DM}; pg8::StaticOrder S; S.init(T, DM, F.G, (int)blockIdx.x);
        EpiOut E{F.x, F.b_out, F.out};
        pg8::gemm_phase<EpiOut, pg8::StaticOrder, true, true>(F.lds + RING_OFF, g, S, E);
        if (BOTH(8)) GRID_BAR();
    }
    if (IN(9)) { ln_phase(F); }
#undef IN
#undef BOTH
#undef GRID_BAR
}

extern "C" void kernel_launch(void* const* d_in, const int* in_sizes, int n_in, void* d_out, int out_size, void* d_ws, size_t ws_size, hipStream_t stream) {
    static int grid = 0;
    if (grid == 0) {
        if (n_in != 17 || in_sizes[0] != T * DM || out_size != T * DM || ws_size < WS_END) { fprintf(stderr, "kernel_launch: shape/workspace mismatch (n_in %d, in0 %d, out %d, ws %zu < %zu)\n", n_in, n_in > 0 ? in_sizes[0] : -1, out_size, ws_size, (size_t)WS_END); grid = -1; return; }
        int dev = 0, cus = 0, per_cu = 0;
        if (hipGetDevice(&dev) != hipSuccess || hipDeviceGetAttribute(&cus, hipDeviceAttributeMultiprocessorCount, dev) != hipSuccess) { grid = -1; return; }
        if (hipFuncSetAttribute((const void*)mk_fwd, hipFuncAttributeMaxDynamicSharedMemorySize, LDS_BYTES) != hipSuccess) { fprintf(stderr, "kernel_launch: hipFuncSetAttribute failed\n"); grid = -1; return; }
        if (hipOccupancyMaxActiveBlocksPerMultiprocessor(&per_cu, (const void*)mk_fwd, NWAVES * 64, LDS_BYTES) != hipSuccess || per_cu < 1) { fprintf(stderr, "kernel_launch: occupancy query says %d blocks/CU\n", per_cu); }
        (void)hipGetLastError();
        grid = cus;
    }
    if (grid < 0) return;
    (void)hipMemsetAsync((char*)d_ws + WS_CTL, 0, CTL_ZERO_BYTES, stream);
    Args a{};
    for (int i = 0; i < 17; ++i) a.in[i] = (const float*)d_in[i];
    a.out = (float*)d_out; a.ws = (unsigned char*)d_ws;
    if (N_LAUNCHES == 1) {
        a.ph_lo = 0; a.ph_hi = N_PHASES; a.li = 0;
        void* kargs[] = {&a};
        hipError_t e = hipLaunchCooperativeKernel((const void*)mk_fwd, dim3(grid), dim3(NWAVES * 64), kargs, LDS_BYTES, stream);
        if (e != hipSuccess) fprintf(stderr, "kernel_launch: cooperative launch failed: %s\n", hipGetErrorString(e));
    } else {
        for (int li = 0; li < N_PHASES; ++li) {
            a.ph_lo = li; a.ph_hi = li + 1; a.li = li;
            hipLaunchKernelGGL(mk_fwd, dim3(grid), dim3(NWAVES * 64), LDS_BYTES, stream, a);
        }
    }
}
```
